# Optimizing an MI355X kernel written in HIP

```python
import jax, jax.numpy as jnp
from jax import lax
import numpy as np

D_MODEL = 1024
BATCH = 1
SEQ = 16384
DEPTH = 1

ATTN_HEADS = 8
HEAD_DIM = 64
ATTN_WIDTH = ATTN_HEADS * HEAD_DIM
ROT_DIM = HEAD_DIM // 4
ROPE_THETA = 500000.0
DILATED_PATTERNS = ((128, 1), (512, 4), (2048, 16))
Q_BLOCK = 128
LRU_WIDTH = D_MODEL - ATTN_WIDTH
LRU_BLOCKS = 8
LRU_BLOCK = LRU_WIDTH // LRU_BLOCKS
CONV_WIDTH = 4
LRU_C = 8.0
IN_WIDTH = 3 * ATTN_WIDTH + 2 * LRU_WIDTH
D_FF = 4 * D_MODEL
EPS = 1e-6

kernel_name = "hymba_style_rglru_dilated_attn_block"


def rms_norm(x, g):
    xf = x.astype(jnp.float32)
    y = xf * lax.rsqrt(jnp.mean(xf * xf, axis=-1, keepdims=True) + EPS)
    return (y * g.astype(jnp.float32)).astype(x.dtype)


def partial_rope(x, cos, sin):
    half = ROT_DIM // 2
    xf = x.astype(jnp.float32)
    x1 = xf[..., :half]
    x2 = xf[..., half:ROT_DIM]
    c = cos[None, :, None, :]
    s = sin[None, :, None, :]
    out = jnp.concatenate([x1 * c - x2 * s, x2 * c + x1 * s, xf[..., ROT_DIM:]], axis=-1)
    return out.astype(x.dtype)


def dilated_attention(q, k, v):
    B, S, H, Dh = q.shape
    scale = HEAD_DIM ** -0.5
    n_blocks = S // Q_BLOCK

    def one_block(start):
        qb = lax.dynamic_slice_in_dim(q, start, Q_BLOCK, axis=1)
        t = start + jnp.arange(Q_BLOCK)
        outs, lses = [], []
        for w, d in DILATED_PATTERNS:
            offs = jnp.arange(w // d + 1) * d
            idx = t[:, None] - offs[None, :]
            valid = idx >= 0
            idx = jnp.maximum(idx, 0)
            kg = jnp.take(k, idx, axis=1)
            vg = jnp.take(v, idx, axis=1)
            s = jnp.einsum('bqhd,bqnhd->bhqn', qb, kg,
                           preferred_element_type=jnp.float32) * scale
            s = jnp.where(valid[None, None], s, -jnp.inf)
            lse = jax.nn.logsumexp(s, axis=-1)
            p = jnp.exp(s - lse[..., None])
            o = jnp.einsum('bhqn,bqnhd->bqhd', p, vg.astype(jnp.float32))
            outs.append(o)
            lses.append(lse)
        alpha = jax.nn.softmax(jnp.stack(lses, axis=0), axis=0)
        alpha = jnp.transpose(alpha, (0, 1, 3, 2))[..., None]
        out = jnp.sum(alpha * jnp.stack(outs, axis=0), axis=0)
        return out.astype(q.dtype)

    starts = jnp.arange(n_blocks) * Q_BLOCK
    blocks = lax.map(one_block, starts)
    return jnp.transpose(blocks, (1, 0, 2, 3, 4)).reshape(B, S, H, Dh)


def _lin_comb(left, right):
    a1, b1 = left
    a2, b2 = right
    return a1 * a2, a2 * b1 + b2


def rg_lru_branch(xb, gate_in, conv_w, conv_b, w_r, b_r, w_i, b_i, lam):
    B, S, _ = xb.shape
    xp = jnp.pad(xb, ((0, 0), (CONV_WIDTH - 1, 0), (0, 0)))
    xc = conv_b + sum(xp[:, j:j + S] * conv_w[j] for j in range(CONV_WIDTH))
    xf = xc.astype(jnp.float32)
    xblk = xf.reshape(B, S, LRU_BLOCKS, LRU_BLOCK)
    r = jax.nn.sigmoid(jnp.einsum('bsnc,ncd->bsnd', xblk, w_r.astype(jnp.float32))
                       + b_r.astype(jnp.float32)).reshape(B, S, LRU_WIDTH)
    i = jax.nn.sigmoid(jnp.einsum('bsnc,ncd->bsnd', xblk, w_i.astype(jnp.float32))
                       + b_i.astype(jnp.float32)).reshape(B, S, LRU_WIDTH)
    log_a = -LRU_C * r * jax.nn.softplus(-lam.astype(jnp.float32))
    a = jnp.exp(log_a)
    bx = jnp.sqrt(-jnp.expm1(2.0 * log_a)) * (i * xf)
    _, h = lax.associative_scan(_lin_comb, (a, bx), axis=1)
    y = jax.nn.gelu(gate_in.astype(jnp.float32)) * h
    return y.astype(xb.dtype)


def setup_inputs(seed: int = 0) -> dict:
    key = jax.random.key(seed)
    ks = jax.random.split(key, 20)
    f32 = jnp.float32
    nrm = lambda k, shape, scale: jax.random.normal(k, shape, f32) * scale
    gain = lambda k, shape: 1.0 + 0.02 * jax.random.normal(k, shape, f32)
    x = jax.random.normal(ks[0], (BATCH, SEQ, D_MODEL), f32)
    u = jax.random.uniform(ks[9], (DEPTH, LRU_WIDTH), f32, 0.9, 0.999)
    a0 = u ** (1.0 / LRU_C)
    lru_lambda = jnp.log(a0) - jnp.log1p(-a0)
    return {
        "x": x,
        "norm1_g": gain(ks[1], (DEPTH, D_MODEL)),
        "w_in": nrm(ks[2], (DEPTH, D_MODEL, IN_WIDTH), D_MODEL ** -0.5),
        "conv_w": nrm(ks[3], (DEPTH, CONV_WIDTH, LRU_WIDTH), CONV_WIDTH ** -0.5),
        "conv_b": nrm(ks[4], (DEPTH, LRU_WIDTH), 0.02),
        "w_rgate": nrm(ks[5], (DEPTH, LRU_BLOCKS, LRU_BLOCK, LRU_BLOCK), LRU_BLOCK ** -0.5),
        "b_rgate": nrm(ks[6], (DEPTH, LRU_BLOCKS, LRU_BLOCK), 0.02),
        "w_igate": nrm(ks[7], (DEPTH, LRU_BLOCKS, LRU_BLOCK, LRU_BLOCK), LRU_BLOCK ** -0.5),
        "b_igate": nrm(ks[8], (DEPTH, LRU_BLOCKS, LRU_BLOCK), 0.02),
        "lru_lambda": lru_lambda,
        "attn_out_g": gain(ks[10], (DEPTH, ATTN_WIDTH)),
        "lru_out_g": gain(ks[11], (DEPTH, LRU_WIDTH)),
        "w_out": nrm(ks[12], (DEPTH, D_MODEL, D_MODEL), D_MODEL ** -0.5),
        "norm2_g": gain(ks[13], (DEPTH, D_MODEL)),
        "w_mlp_up": nrm(ks[14], (DEPTH, D_MODEL, D_FF), D_MODEL ** -0.5),
        "w_mlp_down": nrm(ks[15], (DEPTH, D_FF, D_MODEL), D_FF ** -0.5),
        "final_g": gain(ks[16], (D_MODEL,)),
    }


def reference(x, norm1_g, w_in, conv_w, conv_b, w_rgate, b_rgate, w_igate, b_igate,
              lru_lambda, attn_out_g, lru_out_g, w_out, norm2_g, w_mlp_up, w_mlp_down,
              final_g):
    B, S, _ = x.shape
    pos = jnp.arange(S, dtype=jnp.float32)
    inv_freq = ROPE_THETA ** (-jnp.arange(0, ROT_DIM, 2, dtype=jnp.float32) / ROT_DIM)
    ang = pos[:, None] * inv_freq[None, :]
    cos, sin = jnp.cos(ang), jnp.sin(ang)
    splits = [ATTN_WIDTH, 2 * ATTN_WIDTH, 3 * ATTN_WIDTH, 3 * ATTN_WIDTH + LRU_WIDTH]
    h = x
    for l in range(DEPTH):
        u = rms_norm(h, norm1_g[l])
        z = u @ w_in[l]
        q, k, v, xl, gl = jnp.split(z, splits, axis=-1)
        q = partial_rope(q.reshape(B, S, ATTN_HEADS, HEAD_DIM), cos, sin)
        k = partial_rope(k.reshape(B, S, ATTN_HEADS, HEAD_DIM), cos, sin)
        v = v.reshape(B, S, ATTN_HEADS, HEAD_DIM)
        attn = dilated_attention(q, k, v).reshape(B, S, ATTN_WIDTH)
        lru = rg_lru_branch(xl, gl, conv_w[l], conv_b[l], w_rgate[l], b_rgate[l],
                            w_igate[l], b_igate[l], lru_lambda[l])
        mixed = jnp.concatenate([rms_norm(attn, attn_out_g[l]),
                                 rms_norm(lru, lru_out_g[l])], axis=-1)
        h = h + mixed @ w_out[l]
        u = rms_norm(h, norm2_g[l])
        f = jnp.square(jax.nn.relu(u @ w_mlp_up[l]))
        h = h + f @ w_mlp_down[l]
    return rms_norm(h, final_g)
```

```cpp
#include <hip/hip_runtime.h>
#include <cstdio>
#include <cstdint>
#include <cmath>

#ifndef MK_N_LAUNCHES
#define MK_N_LAUNCHES 9
#endif

#define LAS __attribute__((address_space(3)))
typedef unsigned short bf16_t;
typedef short bf16x8 __attribute__((ext_vector_type(8)));
typedef short s16x4 __attribute__((ext_vector_type(4)));
typedef float f32x4 __attribute__((ext_vector_type(4)));
typedef float f32x16 __attribute__((ext_vector_type(16)));
typedef unsigned u32x4 __attribute__((ext_vector_type(4)));
typedef unsigned u32x2 __attribute__((ext_vector_type(2)));
typedef float f32x2_t __attribute__((ext_vector_type(2)));
typedef __bf16 bf16x2_t __attribute__((ext_vector_type(2)));

constexpr int M = 16384, D = 1024, NZ = 2560, FF = 4096;
constexpr int ZP = NZ;
constexpr int ZQ = 0, ZK = 512, ZV = 1024, ZX = 1536, ZG = 2048;
constexpr int AW = 512, LW = 512;
constexpr float EPS = 1e-6f;
constexpr float QSCALE = 0.125f * 1.4426950408889634f;

__device__ __forceinline__ unsigned cvtpk(float lo, float hi) { f32x2_t v = {lo, hi}; bf16x2_t b = __builtin_convertvector(v, bf16x2_t); return __builtin_bit_cast(unsigned, b); }
__device__ __forceinline__ float bf2f(short s) { return __builtin_bit_cast(float, (unsigned)(unsigned short)s << 16); }
__device__ __forceinline__ float bflo(unsigned u) { return __builtin_bit_cast(float, u << 16); }
__device__ __forceinline__ float bfhi(unsigned u) { return __builtin_bit_cast(float, u & 0xffff0000u); }

namespace pg8 {
constexpr int BM = 256, BK = 64, HALF = 128, HTB = HALF * BK * 2, STAGE_BYTES = 8 * HTB, NXCD = 8, WGM = 8;
__host__ __device__ __forceinline__ int lds_byte(int r, int c) { const int st = (r >> 4) * 2 + (c >> 5), rr = r & 15, cc = c & 31, ob = rr * 64 + cc * 2; return st * 1024 + (ob ^ (((ob >> 9) & 1) << 5)); }
__host__ __device__ __forceinline__ void stage_rc(int b, int& R, int& C) { const int st = b / 1024, sb = b % 1024, swz = sb ^ (((sb >> 9) & 1) << 5); R = (st >> 1) * 16 + swz / 64; C = (st & 1) * 32 + (swz % 64) / 2; }
__host__ __device__ __forceinline__ int perm32(int rho) { const int n = rho >> 4, i = rho & 15; return 8 * (i >> 2) + 4 * n + (i & 3); }
struct Unit { int pm, pn; };
struct Gemm { const bf16_t* A; const bf16_t* Bt; int M, N, K; };
struct StaticOrder {
    int nM, nN, nwg, G, c;
    __device__ void init(int M_, int N_, int G_, int c_) { nM = M_ / BM; nN = N_ / BM; nwg = nM * nN; G = G_; c = c_; }
    __device__ bool next(int i, Unit& u) const {
        const long L = (long)i * G + c; if (L >= nwg) return false;
        int wgid = (int)L; { const int q = nwg / NXCD, r = nwg % NXCD, xcd = wgid % NXCD, off = wgid / NXCD; wgid = (xcd < r ? xcd * (q + 1) : r * (q + 1) + (xcd - r) * q) + off; }
        const int nig = WGM * nN, gid = wgid / nig, fm = gid * WGM, gsz = (nM - fm) < WGM ? (nM - fm) : WGM;
        u.pm = fm + ((wgid % nig) % gsz); u.pn = (wgid % nig) / gsz; return true;
    }
    __device__ __forceinline__ void a_ready(const Unit&) const {}
    __device__ __forceinline__ void done(const Unit&) const {}
};

template <class Epi, class Sched, bool ALIGN_EPI = false, bool SP2 = false>
__device__ __forceinline__ void gemm_phase(LAS unsigned char* lds, const Gemm g, const Sched& S, const Epi& E) {
    const int tid = threadIdx.x, wid = __builtin_amdgcn_readfirstlane(tid >> 6), lane = tid & 63, wr = wid >> 2, wc = wid & 3, fr = lane & 15, fq = lane >> 4;
    const int K = g.K, nt = K / BK;
    unsigned voffA[2], voffB[2];
#pragma unroll
    for (int i = 0; i < 2; ++i) { int R, C; stage_rc(tid * 16 + i * 8192, R, C); const int Rb = Epi::PERM ? ((R & ~31) + perm32(R & 31)) : R;
        voffA[i] = (unsigned)(R * K + C) * 2u; voffB[i] = (unsigned)(Rb * K + C) * 2u; }
    const size_t kstep = (size_t)(BK * 2);
    const size_t hstep = (size_t)HALF * K * 2;
    const size_t tstep = 2 * hstep;
    const unsigned ldsw = (unsigned)wid * 1024u;
    const int aoff = lds_byte(wr * 64 + fr, fq * 8), boff = lds_byte(wc * 32 + fr, fq * 8);
#define PG8_SA(b, h) (((b) * 2 + (h)) * HTB)
#define PG8_SB(b, h) ((4 + (b) * 2 + (h)) * HTB)
#define PG8_STAGE(bufoff, gbase, voff) do { _Pragma("unroll") for (int _i = 0; _i < 2; ++_i) \
        __builtin_amdgcn_global_load_lds((const unsigned*)((const char*)(gbase) + (voff)[_i]), (LAS unsigned*)(lds + (bufoff) + ldsw + _i * 8192), 16, 0, 0); } while (0)
#define PG8_LDA(dst, b, h) do { _Pragma("unroll") for (int m = 0; m < 4; ++m) _Pragma("unroll") for (int k = 0; k < 2; ++k) dst[m][k] = *(const LAS bf16x8*)(lds + PG8_SA(b, h) + aoff + m * 2048 + k * 1024); } while (0)
#define PG8_LDB(dst, b, h) do { _Pragma("unroll") for (int n = 0; n < 2; ++n) _Pragma("unroll") for (int k = 0; k < 2; ++k) dst[n][k] = *(const LAS bf16x8*)(lds + PG8_SB(b, h) + boff + n * 2048 + k * 1024); } while (0)
#define PG8_MMA(ai, bj, At, Bt) do { __builtin_amdgcn_s_setprio(1); _Pragma("unroll") for (int m = 0; m < 4; ++m) _Pragma("unroll") for (int n = 0; n < 2; ++n) _Pragma("unroll") for (int k = 0; k < 2; ++k) \
        acc[ai][bj][m][n] = __builtin_amdgcn_mfma_f32_16x16x32_bf16(Bt[n][k], At[m][k], acc[ai][bj][m][n], 0, 0, 0); __builtin_amdgcn_s_setprio(0); } while (0)
#define PG8_WAIT_V(n) asm volatile("s_waitcnt vmcnt(" #n ")" ::: "memory")
#define PG8_WAIT_L(n) asm volatile("s_waitcnt lgkmcnt(" #n ")" ::: "memory")
#define PG8_BAR __builtin_amdgcn_s_barrier()
#define PG8_SCHED __builtin_amdgcn_sched_barrier(0)
    Unit cur, nxt; int ui = 0;
    if (!S.next(0, cur)) return;
    f32x4 acc[2][2][4][2];
#pragma unroll
    for (int a = 0; a < 2; ++a)
#pragma unroll
        for (int b = 0; b < 2; ++b)
#pragma unroll
            for (int m = 0; m < 4; ++m)
#pragma unroll
                for (int n = 0; n < 2; ++n) acc[a][b][m][n] = (f32x4){0.f, 0.f, 0.f, 0.f};
    bf16x8 At[4][2], B0[2][2], B1[2][2];
    const char* cA = (const char*)g.A + (size_t)cur.pm * tstep; const char* cB = (const char*)g.Bt + (size_t)cur.pn * tstep;
    S.a_ready(cur);
    if constexpr (SP2) {
        PG8_STAGE(PG8_SB(0, 0), cB, voffB); PG8_STAGE(PG8_SB(0, 1), cB + hstep, voffB); PG8_STAGE(PG8_SA(0, 0), cA, voffA); PG8_STAGE(PG8_SA(0, 1), cA + hstep, voffA);
        if (wr == 1) PG8_BAR;
        PG8_WAIT_V(2); PG8_BAR;
        PG8_STAGE(PG8_SB(1, 0), cB + kstep, voffB); PG8_STAGE(PG8_SA(1, 0), cA + kstep, voffA); PG8_STAGE(PG8_SB(1, 1), cB + hstep + kstep, voffB);
        PG8_WAIT_V(6); PG8_BAR;
    } else {
        PG8_STAGE(PG8_SB(0, 0), cB, voffB); PG8_STAGE(PG8_SA(0, 0), cA, voffA); PG8_STAGE(PG8_SB(0, 1), cB + hstep, voffB); PG8_STAGE(PG8_SA(0, 1), cA + hstep, voffA);
        if (wr == 1) PG8_BAR;
        PG8_WAIT_V(4); PG8_BAR;
        PG8_STAGE(PG8_SB(1, 0), cB + kstep, voffB); PG8_STAGE(PG8_SA(1, 0), cA + kstep, voffA); PG8_STAGE(PG8_SB(1, 1), cB + hstep + kstep, voffB);
        PG8_WAIT_V(6); PG8_BAR;
    }
    for (;;) {
        const bool has_next = S.next(ui + 1, nxt);
        const char* nA = has_next ? (const char*)g.A + (size_t)nxt.pm * tstep : cA; const char* nB = has_next ? (const char*)g.Bt + (size_t)nxt.pn * tstep : cB;
        for (int t = 0; t < nt; t += 2) {
            const bool last = (t == nt - 2);
            const char* a1 = cA + (size_t)(t + 1) * kstep;
            const char* a2 = last ? nA : cA + (size_t)(t + 2) * kstep; const char* b2 = last ? nB : cB + (size_t)(t + 2) * kstep;
            const char* a3 = a2 + kstep; const char* b3 = b2 + kstep;
            if (last && has_next) S.a_ready(nxt);
            if constexpr (SP2) {
            PG8_LDB(B0, 0, 0); PG8_LDB(B1, 0, 1); PG8_SCHED; PG8_LDA(At, 0, 0); PG8_STAGE(PG8_SA(1, 1), a1 + hstep, voffA);
            PG8_WAIT_V(8); PG8_WAIT_L(0); PG8_BAR; PG8_MMA(0, 0, At, B0); PG8_MMA(0, 1, At, B1); PG8_BAR; PG8_SCHED;
            PG8_LDA(At, 0, 1); PG8_STAGE(PG8_SB(0, 0), b2, voffB); PG8_STAGE(PG8_SB(0, 1), b2 + hstep, voffB); PG8_STAGE(PG8_SA(0, 0), a2, voffA);
            PG8_WAIT_V(8); PG8_WAIT_L(0); PG8_BAR; PG8_MMA(1, 0, At, B0); PG8_MMA(1, 1, At, B1); PG8_BAR; PG8_SCHED;
            PG8_LDB(B0, 1, 0); PG8_LDB(B1, 1, 1); PG8_SCHED; PG8_LDA(At, 1, 0); PG8_STAGE(PG8_SA(0, 1), a2 + hstep, voffA);
            PG8_WAIT_V(8); PG8_WAIT_L(0); PG8_BAR; PG8_MMA(0, 0, At, B0); PG8_MMA(0, 1, At, B1); PG8_BAR; PG8_SCHED;
            PG8_LDA(At, 1, 1); PG8_STAGE(PG8_SB(1, 0), b3, voffB); PG8_STAGE(PG8_SB(1, 1), b3 + hstep, voffB); PG8_STAGE(PG8_SA(1, 0), a3, voffA);
            PG8_WAIT_V(8); PG8_WAIT_L(0); PG8_BAR; PG8_MMA(1, 0, At, B0); PG8_MMA(1, 1, At, B1); PG8_BAR; PG8_SCHED;
            } else {
            PG8_LDB(B0, 0, 0); PG8_SCHED; PG8_LDA(At, 0, 0); PG8_STAGE(PG8_SA(1, 1), a1 + hstep, voffA);
            PG8_WAIT_L(8); PG8_BAR; PG8_WAIT_L(0); PG8_MMA(0, 0, At, B0); PG8_BAR; PG8_SCHED;
            PG8_LDB(B1, 0, 1); PG8_STAGE(PG8_SB(0, 0), b2, voffB);
            PG8_BAR; PG8_WAIT_L(0); PG8_MMA(0, 1, At, B1); PG8_BAR;
            PG8_LDA(At, 0, 1); PG8_STAGE(PG8_SA(0, 0), a2, voffA);
            PG8_BAR; PG8_WAIT_L(0); PG8_MMA(1, 0, At, B0); PG8_BAR; PG8_SCHED;
            PG8_STAGE(PG8_SB(0, 1), b2 + hstep, voffB);
            PG8_WAIT_V(6); PG8_BAR; PG8_MMA(1, 1, At, B1); PG8_BAR;
            PG8_LDB(B0, 1, 0); PG8_SCHED; PG8_LDA(At, 1, 0); PG8_STAGE(PG8_SA(0, 1), a2 + hstep, voffA);
            PG8_WAIT_L(8); PG8_BAR; PG8_WAIT_L(0); PG8_MMA(0, 0, At, B0); PG8_BAR; PG8_SCHED;
            PG8_LDB(B1, 1, 1); PG8_STAGE(PG8_SB(1, 0), b3, voffB);
            PG8_BAR; PG8_WAIT_L(0); PG8_MMA(0, 1, At, B1); PG8_BAR;
            PG8_LDA(At, 1, 1); PG8_STAGE(PG8_SA(1, 0), a3, voffA);
            PG8_BAR; PG8_WAIT_L(0); PG8_MMA(1, 0, At, B0); PG8_BAR; PG8_SCHED;
            PG8_STAGE(PG8_SB(1, 1), b3 + hstep, voffB);
            PG8_WAIT_V(6); PG8_BAR; PG8_MMA(1, 1, At, B1); PG8_BAR;
            }
        }
        if constexpr (ALIGN_EPI) { if (wr == 0) PG8_BAR; }
        if constexpr (!Epi::AFTER_DRAIN) { E(acc, cur, wr, wc, fr, fq); S.done(cur); }
        if (!has_next) break;
#pragma unroll
        for (int a = 0; a < 2; ++a)
#pragma unroll
            for (int b = 0; b < 2; ++b)
#pragma unroll
                for (int m = 0; m < 4; ++m)
#pragma unroll
                    for (int n = 0; n < 2; ++n) acc[a][b][m][n] = (f32x4){0.f, 0.f, 0.f, 0.f};
        cur = nxt; cA = nA; cB = nB; ++ui;
        if constexpr (ALIGN_EPI) { if (wr == 1) PG8_BAR; }
    }
    PG8_WAIT_V(0);
    if constexpr (!ALIGN_EPI) { if (wr == 0) PG8_BAR; }
    PG8_BAR;
    if constexpr (Epi::AFTER_DRAIN) { E.fused(acc, cur, wr, wc, fr, fq, lds, wid, lane); S.done(cur); }
#undef PG8_SA
#undef PG8_SB
#undef PG8_STAGE
#undef PG8_LDA
#undef PG8_LDB
#undef PG8_MMA
#undef PG8_WAIT_V
#undef PG8_WAIT_L
#undef PG8_BAR
#undef PG8_SCHED
}
}

__device__ __forceinline__ float gelu_tanh(float x) {
    const float u2 = 1.5957691216057308f * (x + 0.044715f * x * x * x);
    return x * __builtin_amdgcn_rcpf(1.0f + __builtin_amdgcn_exp2f(-1.4426950408889634f * u2));
}
struct EpiZ {
    static constexpr bool PERM = true, AFTER_DRAIN = false;
    bf16_t* Z; const float* rope;
    __device__ __forceinline__ void operator()(const f32x4 (&acc)[2][2][4][2], const pg8::Unit& u, int wr, int wc, int fr, int fq) const {
        const int row0 = u.pm * 256 + wr * 64 + fr, kind = u.pn >> 1, col0 = u.pn * 256 + wc * 32 + 8 * fq;
        const bool dorope = (kind < 2) && ((wc & 1) == 0) && (fq < 2);
        const float sc = (kind == 0) ? QSCALE : 1.0f;
#pragma unroll
        for (int ai = 0; ai < 2; ++ai)
#pragma unroll
            for (int m = 0; m < 4; ++m) { const int row = row0 + ai * 128 + m * 16; bf16_t* rowp = Z + (size_t)row * ZP + col0;
                f32x4 cs = (f32x4){1.f, 1.f, 1.f, 1.f}, sn = (f32x4){0.f, 0.f, 0.f, 0.f};
                if (dorope) { cs = *(const f32x4*)(rope + (size_t)row * 16 + 4 * fq); sn = *(const f32x4*)(rope + (size_t)row * 16 + 8 + 4 * fq); }
#pragma unroll
                for (int bj = 0; bj < 2; ++bj) { f32x4 v0 = acc[ai][bj][m][0], v1 = acc[ai][bj][m][1];
                    if (kind < 2) { const f32x4 a = v0 * cs - v1 * sn, b = v1 * cs + v0 * sn; v0 = a * sc; v1 = b * sc; }
                    if (kind == 4) {
#pragma unroll
                        for (int j = 0; j < 4; ++j) { v0[j] = gelu_tanh(v0[j]); v1[j] = gelu_tanh(v1[j]); } }
                    u32x4 w; w.x = cvtpk(v0[0], v0[1]); w.y = cvtpk(v0[2], v0[3]); w.z = cvtpk(v1[0], v1[1]); w.w = cvtpk(v1[2], v1[3]);
                    *(u32x4*)(rowp + bj * 128) = w; } }
    }
};
struct EpiRes {
    static constexpr bool PERM = false, AFTER_DRAIN = false;
    const float* base; float* out;
    __device__ __forceinline__ void operator()(const f32x4 (&acc)[2][2][4][2], const pg8::Unit& u, int wr, int wc, int fr, int fq) const {
        const int row0 = u.pm * 256 + wr * 64 + fr, col0 = u.pn * 256 + wc * 32 + 4 * fq;
#pragma unroll
        for (int ai = 0; ai < 2; ++ai)
#pragma unroll
            for (int m = 0; m < 4; ++m) { const size_t off = (size_t)(row0 + ai * 128 + m * 16) * D + col0;
#pragma unroll
                for (int bj = 0; bj < 2; ++bj)
#pragma unroll
                    for (int n = 0; n < 2; ++n) { const f32x4 b = *(const f32x4*)(base + off + bj * 128 + n * 16); *(f32x4*)(out + off + bj * 128 + n * 16) = b + acc[ai][bj][m][n]; } }
    }
};
struct EpiRelu2 {
    static constexpr bool PERM = true, AFTER_DRAIN = false;
    bf16_t* O;
    __device__ __forceinline__ void operator()(const f32x4 (&acc)[2][2][4][2], const pg8::Unit& u, int wr, int wc, int fr, int fq) const {
        const int row0 = u.pm * 256 + wr * 64 + fr, col0 = u.pn * 256 + wc * 32 + 8 * fq;
#pragma unroll
        for (int ai = 0; ai < 2; ++ai)
#pragma unroll
            for (int m = 0; m < 4; ++m) { bf16_t* rowp = O + (size_t)(row0 + ai * 128 + m * 16) * FF + col0;
#pragma unroll
                for (int bj = 0; bj < 2; ++bj) { f32x4 v0 = acc[ai][bj][m][0], v1 = acc[ai][bj][m][1];
#pragma unroll
                    for (int j = 0; j < 4; ++j) { const float a = fmaxf(v0[j], 0.f), b = fmaxf(v1[j], 0.f); v0[j] = a * a; v1[j] = b * b; }
                    u32x4 w; w.x = cvtpk(v0[0], v0[1]); w.y = cvtpk(v0[2], v0[3]); w.z = cvtpk(v1[0], v1[1]); w.w = cvtpk(v1[2], v1[3]);
                    *(u32x4*)(rowp + bj * 128) = w; } }
    }
};

constexpr size_t MiB = 1u << 20;
constexpr size_t WS_CTL = 0, CTL_ZERO_BYTES = 64 * 1024;
constexpr size_t WS_WIN = 1 * MiB;
constexpr size_t WS_WOUT = 6 * MiB;
constexpr size_t WS_WUP = 8 * MiB;
constexpr size_t WS_WDN = 16 * MiB;
constexpr size_t WS_WG = 24 * MiB;
constexpr size_t WS_ROPE = 25 * MiB;
constexpr size_t WS_AGG = 26 * MiB;
constexpr size_t WS_SUP = 27 * MiB;
constexpr size_t WS_XN = 32 * MiB;
constexpr size_t WS_Z = 64 * MiB;
constexpr size_t WS_ATT = 144 * MiB;
constexpr size_t WS_MIX = 160 * MiB;
constexpr size_t WS_H = 64 * MiB;
constexpr size_t WS_END = 192 * MiB;
constexpr int CW_BAR = 1024;

constexpr int LDS_BYTES = 155648;
constexpr int RING_BYTES = 131072;
constexpr int MISC_OFF = LDS_BYTES - 256;

#define XB_TMO      128
#define XB_XCNT(j)  (256  + 64 * (j))
#define XB_XSUB(j)  (1280 + 64 * (j))
#define XB_XGEN(j)  (2304 + 64 * (j))
#define XB_TOP      3328
#define XB_TOPGEN   3392
#define XCD_BAR_WORDS 3456
#define XB_SPIN_CAP (1u << 18)
__device__ __forceinline__ unsigned xb_ld(unsigned* p)              { return __hip_atomic_load(p, __ATOMIC_RELAXED, __HIP_MEMORY_SCOPE_AGENT); }
__device__ __forceinline__ unsigned xb_add(unsigned* p, unsigned v) { return __hip_atomic_fetch_add(p, v, __ATOMIC_RELAXED, __HIP_MEMORY_SCOPE_AGENT); }
__device__ __forceinline__ unsigned xb_xcc_id() { return (unsigned)__builtin_amdgcn_s_getreg((3 << 11) | 20) & 0xFu; }
#define XB_SPIN(cond, bar) do { unsigned _sp = 0; while (cond) { __builtin_amdgcn_s_sleep(1); \
    if ((++_sp & 255u) == 0u) { if (xb_ld(&(bar)[XB_TMO])) break; if (_sp > XB_SPIN_CAP) { atomicAdd(&(bar)[XB_TMO], 1u); break; } } } } while (0)
struct XcdBarrier { unsigned* bar; unsigned x; volatile LAS unsigned* st; };
__device__ __forceinline__ XcdBarrier xcd_barrier_post(unsigned* bar, volatile LAS unsigned* st) {
    XcdBarrier b; b.bar = bar; b.x = xb_xcc_id(); b.st = st;
    if (threadIdx.x == 0) (void)xb_add(&bar[XB_XCNT(b.x)], 1u);
    return b;
}
__device__ __forceinline__ void xcd_barrier_complete(unsigned* bar, unsigned x, unsigned& nloc, unsigned& nx) {
    const unsigned G = gridDim.x * gridDim.y * gridDim.z;
    unsigned sum, cnt, mine, sp = 0u;
    for (;;) {
        sum = 0u; cnt = 0u; mine = 0u;
#pragma unroll
        for (unsigned j = 0; j < 16; ++j) { const unsigned c = xb_ld(&bar[XB_XCNT(j)]); sum += c; cnt += (c > 0u) ? 1u : 0u; mine = (j == x) ? c : mine; }
        if (sum == G) break;
        __builtin_amdgcn_s_sleep(1);
        if ((++sp & 255u) == 0u) { if (xb_ld(&bar[XB_TMO])) break; if (sp > XB_SPIN_CAP) { atomicAdd(&bar[XB_TMO], 1u); break; } }
    }
    nloc = mine > 0u ? mine : 1u; nx = cnt > 0u ? cnt : 1u;
}
__device__ __forceinline__ void xcd_barrier(const XcdBarrier& b) {
    asm volatile("s_waitcnt vmcnt(0)" ::: "memory");
    __syncthreads();
    if (threadIdx.x == 0) {
        unsigned* bar = b.bar;
        __builtin_amdgcn_s_waitcnt(0);
        unsigned nloc = b.st[0], nx = b.st[1];
        if (nloc == 0u) { xcd_barrier_complete(bar, b.x, nloc, nx); b.st[0] = nloc; b.st[1] = nx; }
        const unsigned old = xb_add(&bar[XB_XSUB(b.x)], 1u);
        const unsigned gen = old / nloc;
        if (old + 1u == (gen + 1u) * nloc) {
            __builtin_amdgcn_fence(__ATOMIC_RELEASE, "agent");
            asm volatile("s_waitcnt vmcnt(0)" ::: "memory");
            const unsigned og = xb_add(&bar[XB_TOP], 1u);
            const unsigned tg = og / nx;
            if (og + 1u == (tg + 1u) * nx) xb_add(&bar[XB_TOPGEN], 1u);
            else XB_SPIN(xb_ld(&bar[XB_TOPGEN]) == tg, bar);
            __builtin_amdgcn_fence(__ATOMIC_ACQUIRE, "agent");
            xb_add(&bar[XB_XGEN(b.x)], 1u);
            asm volatile("s_waitcnt vmcnt(0)" ::: "memory");
        } else {
            XB_SPIN(xb_ld(&bar[XB_XGEN(b.x)]) == gen, bar);
            __builtin_amdgcn_fence(__ATOMIC_ACQUIRE, "agent");
            asm volatile("s_waitcnt vmcnt(0)" ::: "memory");
        }
    }
    __syncthreads();
}

struct Frame {
    LAS unsigned char* lds;
    int tid, lane, wave, vcu, G;
    const float *x, *g1, *w_in, *conv_w, *conv_b, *w_r, *b_r, *w_i, *b_i, *lam, *ga, *gl, *w_out, *g2, *w_up, *w_dn, *gf;
    float* out;
    bf16_t *Win_t, *Wout_t, *Wup_t, *Wdn_t, *WtR, *WtI, *XN, *Z, *ATT, *MIX, *H;
    float *rope, *AGG, *SUP;
    float invf[8];
};
__device__ __forceinline__ float wave_sum(float v) {
#pragma unroll
    for (int o = 1; o < 64; o <<= 1) v += __shfl_xor(v, o);
    return v;
}
__device__ __forceinline__ unsigned f2bf(float f) { unsigned u = __builtin_bit_cast(unsigned, f); return (u + 0x7fffu + ((u >> 16) & 1u)) >> 16; }
__device__ __forceinline__ unsigned pk2(float lo, float hi) { return f2bf(lo) | (f2bf(hi) << 16); }

__device__ __forceinline__ int qk_row(int n) {
    if (n < 1024 && (n & 63) < 16) { const int l = n & 15; return (n & ~15) + 8 * ((l >> 2) & 1) + 4 * (l >> 3) + (l & 3); }
    return n;
}
__device__ __forceinline__ void p0_transpose_item(const float* W, int K, int N, bf16_t* WT, bool permqk, LAS float* scr, int item, int lane) {
    const int nblk = N / 32, kb = item / nblk, nb = item % nblk, k0 = 64 * kb, n0 = 32 * nb;
#pragma unroll 8
    for (int i = 0; i < 32; ++i) { const int kk = 2 * i + (lane >> 5); scr[kk * 33 + (lane & 31)] = W[(size_t)(k0 + kk) * N + n0 + (lane & 31)]; }
    asm volatile("s_waitcnt lgkmcnt(0)" ::: "memory");
    const int c = lane & 7;
#pragma unroll
    for (int j = 0; j < 4; ++j) { const int n = (lane >> 3) + 8 * j; const LAS float* s = scr + (8 * c) * 33 + n;
        u32x4 o; o.x = pk2(s[0 * 33], s[1 * 33]); o.y = pk2(s[2 * 33], s[3 * 33]); o.z = pk2(s[4 * 33], s[5 * 33]); o.w = pk2(s[6 * 33], s[7 * 33]);
        const int drow = permqk ? qk_row(n0 + n) : (n0 + n);
        *(u32x4*)(WT + (size_t)drow * K + k0 + 8 * c) = o; }
    asm volatile("s_waitcnt lgkmcnt(0)" ::: "memory");
}
__device__ __forceinline__ void rms_row_to_bf16(const float* xrow, const float* g, bf16_t* orow, int lane) {
    const f32x4* xr = (const f32x4*)xrow + lane; const f32x4* gr = (const f32x4*)g + lane;
    f32x4 v[4]; float s = 0.f;
#pragma unroll
    for (int j = 0; j < 4; ++j) { v[j] = xr[64 * j]; s += (v[j].x * v[j].x + v[j].y * v[j].y) + (v[j].z * v[j].z + v[j].w * v[j].w); }
    const float rstd = 1.0f / sqrtf(wave_sum(s) * (1.f / D) + EPS);
    unsigned long long* o8 = (unsigned long long*)orow + lane;
#pragma unroll
    for (int j = 0; j < 4; ++j) { const f32x4 gg = gr[64 * j]; const f32x4 y = v[j] * rstd * gg;
        o8[64 * j] = (unsigned long long)cvtpk(y.x, y.y) | ((unsigned long long)cvtpk(y.z, y.w) << 32); }
}
__device__ __forceinline__ void p0_prologue(Frame& F) {
    LAS float* scr = (LAS float*)(F.lds + F.wave * 16384);
    const int gw = F.vcu * 8 + F.wave, NGW = F.G * 8;
    constexpr int I_IN = (D / 64) * (NZ / 32), I_OUT = (D / 64) * (D / 32), I_UP = (D / 64) * (FF / 32), I_DN = (FF / 64) * (D / 32);
    constexpr int NITEMS = I_IN + I_OUT + I_UP + I_DN;
    for (int it = gw; it < NITEMS; it += NGW) {
        int r = it;
        if (r < I_IN) { p0_transpose_item(F.w_in, D, NZ, F.Win_t, true, scr, r, F.lane); continue; } r -= I_IN;
        if (r < I_OUT) { p0_transpose_item(F.w_out, D, D, F.Wout_t, false, scr, r, F.lane); continue; } r -= I_OUT;
        if (r < I_UP) { p0_transpose_item(F.w_up, D, FF, F.Wup_t, false, scr, r, F.lane); continue; } r -= I_UP;
        p0_transpose_item(F.w_dn, FF, D, F.Wdn_t, false, scr, r, F.lane);
    }
    const int gt = (F.vcu * 8 + F.wave) * 64 + F.lane, NGT = F.G * 512;
    for (int i = gt; i < 2 * 32768; i += NGT) { const int which = i >> 15, e = i & 32767, n = e >> 12, d = (e >> 6) & 63, c = e & 63;
        const float v = (which ? F.w_i : F.w_r)[(n * 64 + c) * 64 + d]; (which ? F.WtI : F.WtR)[e] = (bf16_t)f2bf(v); }
    for (int t = gt; t < M; t += NGT) {
#pragma unroll
        for (int k = 0; k < 8; ++k) { const float ang = (float)t * F.invf[k]; F.rope[(size_t)t * 16 + k] = cosf(ang); F.rope[(size_t)t * 16 + 8 + k] = sinf(ang); } }
    for (int m = gw; m < M; m += NGW) rms_row_to_bf16(F.x + (size_t)m * D, F.g1, F.XN + (size_t)m * D, F.lane);
}

__device__ __forceinline__ int crow(int r, int hi) { return (r & 3) + 8 * (r >> 2) + 4 * hi; }
__device__ __forceinline__ float swap_lo(float v, float& hi_out) {
    auto rr = __builtin_amdgcn_permlane32_swap(__float_as_uint(v), __float_as_uint(v), false, false);
    const unsigned r0 = rr[0], r1 = rr[1];
    hi_out = __uint_as_float(r1); return __uint_as_float(r0);
}
__device__ __forceinline__ float sigmoidf_(float x) { return __builtin_amdgcn_rcpf(1.0f + __builtin_amdgcn_exp2f(-1.4426950408889634f * x)); }

struct LruWave {
    bf16x8 wfr[2][4], wfi[2][4]; float br[2], bi[2], sp8[2];
};
__device__ __forceinline__ void lru_wave_init(const Frame& F, int n, LruWave& W) {
    const int c31 = F.lane & 31, hh = F.lane >> 5;
#pragma unroll
    for (int ct = 0; ct < 2; ++ct) {
#pragma unroll
        for (int ks = 0; ks < 4; ++ks) { const size_t off = (size_t)((n * 64 + 32 * ct + c31) * 64 + 16 * ks + 8 * hh);
            W.wfr[ct][ks] = *(const bf16x8*)(F.WtR + off); W.wfi[ct][ks] = *(const bf16x8*)(F.WtI + off); }
        const int ch = 64 * n + 32 * ct + c31; W.br[ct] = F.b_r[ch]; W.bi[ct] = F.b_i[ch];
        const float xm = -F.lam[ch]; W.sp8[ct] = 8.0f * (fmaxf(xm, 0.f) + log1pf(expf(-fabsf(xm))));
    }
}
__device__ __forceinline__ void lru_tile_prep(const Frame& F, int n, int tb, LAS float* XCw, bf16x8 (&af)[4]) {
    const int c31 = F.lane & 31, hh = F.lane >> 5, tok = tb + c31;
    int opq = 0; asm volatile("" : "+v"(opq));
#pragma unroll
    for (int ks = 0; ks < 4; ++ks) {
        const int ch0 = 64 * n + 16 * ks + 8 * hh + opq;
        const bf16_t* xp = F.Z + (size_t)tok * ZP + ZX + ch0;
        const bf16x8 z8 = (bf16x8){0, 0, 0, 0, 0, 0, 0, 0};
        const bf16x8 x3 = *(const bf16x8*)xp;
        const bf16x8 x2 = tok >= 1 ? *(const bf16x8*)(xp - ZP) : z8;
        const bf16x8 x1 = tok >= 2 ? *(const bf16x8*)(xp - 2 * ZP) : z8;
        const bf16x8 x0 = tok >= 3 ? *(const bf16x8*)(xp - 3 * ZP) : z8;
        float xc[8];
#pragma unroll
        for (int hf = 0; hf < 2; ++hf) {
            const f32x4 w0 = *(const f32x4*)(F.conv_w + 0 * LW + ch0 + 4 * hf), w1 = *(const f32x4*)(F.conv_w + 1 * LW + ch0 + 4 * hf);
            const f32x4 w2 = *(const f32x4*)(F.conv_w + 2 * LW + ch0 + 4 * hf), w3 = *(const f32x4*)(F.conv_w + 3 * LW + ch0 + 4 * hf);
            const f32x4 cb = *(const f32x4*)(F.conv_b + ch0 + 4 * hf);
#pragma unroll
            for (int j = 0; j < 4; ++j) { const int e = 4 * hf + j;
                xc[e] = cb[j] + (((bf2f(x0[e]) * w0[j] + bf2f(x1[e]) * w1[j]) + bf2f(x2[e]) * w2[j]) + bf2f(x3[e]) * w3[j]); }
        }
        LAS float* dst = XCw + c31 * 68 + 16 * ks + 8 * hh;
        *(LAS f32x4*)dst = (f32x4){xc[0], xc[1], xc[2], xc[3]}; *(LAS f32x4*)(dst + 4) = (f32x4){xc[4], xc[5], xc[6], xc[7]};
        u32x4 pk; pk.x = cvtpk(xc[0], xc[1]); pk.y = cvtpk(xc[2], xc[3]); pk.z = cvtpk(xc[4], xc[5]); pk.w = cvtpk(xc[6], xc[7]);
        af[ks] = __builtin_bit_cast(bf16x8, pk);
    }
}
__device__ __forceinline__ void lru_tile_ct(const Frame& F, const LruWave& W, int ct, const LAS float* XCw, const bf16x8 (&af)[4], float (&a)[16], float (&bx)[16]) {
    const int c31 = F.lane & 31, hh = F.lane >> 5;
    f32x16 pr = {}, pi = {};
#pragma unroll
    for (int ks = 0; ks < 4; ++ks) { pr = __builtin_amdgcn_mfma_f32_32x32x16_bf16(af[ks], W.wfr[ct][ks], pr, 0, 0, 0); pi = __builtin_amdgcn_mfma_f32_32x32x16_bf16(af[ks], W.wfi[ct][ks], pi, 0, 0, 0); }
#pragma unroll
    for (int r = 0; r < 16; ++r) {
        const float xcv = XCw[crow(r, hh) * 68 + 32 * ct + c31];
        const float rg = sigmoidf_(pr[r] + W.br[ct]), ig = sigmoidf_(pi[r] + W.bi[ct]);
        const float la = -rg * W.sp8[ct];
        a[r] = __expf(la);
        bx[r] = sqrtf(-expm1f(2.0f * la)) * (ig * xcv);
    }
}

__device__ __forceinline__ void lru_pass_a(Frame& F) {
    const int c31 = F.lane & 31, hh = F.lane >> 5;
    LAS float* XCw = (LAS float*)(F.lds + F.wave * 8704);
    LAS float* SA = (LAS float*)(F.lds + 8 * 8704);
    for (int u = F.vcu; u < 256; u += F.G) {
        const int s = u >> 3, n = u & 7, chunk = 8 * s + F.wave;
        LruWave W; lru_wave_init(F, n, W);
        float Ac[2] = {1.f, 1.f}, Bc[2] = {0.f, 0.f};
#pragma unroll 1
        for (int tt = 0; tt < 2; ++tt) {
            bf16x8 af[4];
            lru_tile_prep(F, n, chunk * 64 + tt * 32, XCw, af);
#pragma unroll
            for (int ct = 0; ct < 2; ++ct) {
                float a[16], bx[16];
                lru_tile_ct(F, W, ct, XCw, af, a, bx);
#pragma unroll
                for (int g = 0; g < 4; ++g) {
                    float Ag = 1.f, Bg = 0.f;
#pragma unroll
                    for (int k = 0; k < 4; ++k) { Bg = a[4 * g + k] * Bg + bx[4 * g + k]; Ag *= a[4 * g + k]; }
                    float A1, B1; const float A0 = swap_lo(Ag, A1), B0 = swap_lo(Bg, B1);
                    Bc[ct] = A0 * Bc[ct] + B0; Ac[ct] *= A0;
                    Bc[ct] = A1 * Bc[ct] + B1; Ac[ct] *= A1;
                }
            }
        }
        if (hh == 0) {
#pragma unroll
            for (int ct = 0; ct < 2; ++ct) { const int ch = 32 * ct + c31;
                *(f32x2_t*)(F.AGG + ((size_t)chunk * LW + 64 * n + ch) * 2) = (f32x2_t){Ac[ct], Bc[ct]};
                SA[(F.wave * 64 + ch) * 2] = Ac[ct]; SA[(F.wave * 64 + ch) * 2 + 1] = Bc[ct]; }
        }
        __syncthreads();
        if (F.wave == 0) { float A = 1.f, B = 0.f;
#pragma unroll
            for (int w = 0; w < 8; ++w) { const float a_ = SA[(w * 64 + F.lane) * 2], b_ = SA[(w * 64 + F.lane) * 2 + 1]; B = a_ * B + b_; A *= a_; }
            *(f32x2_t*)(F.SUP + ((size_t)s * LW + 64 * n + F.lane) * 2) = (f32x2_t){A, B}; }
        __syncthreads();
    }
}

__device__ __forceinline__ void attn_phase(Frame& F) {
    const int lane = F.lane, qi = lane & 31, hh = lane >> 5;
    LAS unsigned char* Vl = F.lds + F.wave * 4096;
    const int vwr = lane >> 3, vc8 = lane & 7;
    const int trq = (lane & 15) >> 2, trcol2 = 32 * ((lane >> 4) & 1) + 8 * (lane & 3);
    const int trsw = ((trq >> 1) & 1) << 6;
    for (int u = F.vcu; u < 512; u += F.G) {
        const int g = u & 1, h = (u >> 1) & 7, b = u >> 4;
        const int rho = 8 * g + F.wave;
        const int tq = 512 * b + rho + 16 * qi;
        bf16x8 qf[4];
#pragma unroll
        for (int s = 0; s < 4; ++s) qf[s] = *(const bf16x8*)(F.Z + (size_t)tq * ZP + ZQ + h * 64 + 16 * s + 8 * hh);
        float mrun = -1e30f, lrun = 0.f; f32x16 o0 = {}, o1 = {};
        const bf16_t* Kb = F.Z + ZK + h * 64 + 8 * hh;
        const bf16_t* Vb = F.Z + ZV + h * 64 + 8 * vc8;
        for (int blk = 0; blk < 33; ++blk) {
            int d, rd, kb, kq;
            if (blk < 5)       { d = 16; rd = rho;     kb = 32 * b - 128 + 32 * blk;         kq = 32 * b + qi; }
            else if (blk < 13) { d = 4;  rd = rho & 3; kb = 128 * b - 128 + 32 * (blk - 5);  kq = 128 * b + (rho >> 2) + 4 * qi; }
            else               { d = 1;  rd = 0;       kb = 512 * b - 128 + 32 * (blk - 13); kq = 512 * b + rho + 16 * qi; }
            if (kb + 31 < 0) continue;
            const int kk = kb + qi; const int ktok = rd + d * (kk < 0 ? 0 : kk);
            bf16x8 kf[4];
#pragma unroll
            for (int s = 0; s < 4; ++s) kf[s] = *(const bf16x8*)(Kb + (size_t)ktok * ZP + 16 * s);
            u32x4 vv[4];
#pragma unroll
            for (int it = 0; it < 4; ++it) { const int vk = kb + 8 * it + vwr; const int vtok = rd + d * (vk < 0 ? 0 : vk); vv[it] = *(const u32x4*)(Vb + (size_t)vtok * ZP); }
#pragma unroll
            for (int it = 0; it < 4; ++it) { const int row = 8 * it + vwr; *(LAS u32x4*)(Vl + row * 128 + ((vc8 * 16) ^ (((row >> 1) & 1) << 6))) = vv[it]; }
            const int lim = kq < 128 ? kq : 128; const int base = kq - kb - 4 * hh;
            f32x16 sc;
#pragma unroll
            for (int r = 0; r < 16; ++r) { const int df = base - ((r & 3) + 8 * (r >> 2)); sc[r] = ((unsigned)df <= (unsigned)lim) ? 0.f : -INFINITY; }
#pragma unroll
            for (int s = 0; s < 4; ++s) sc = __builtin_amdgcn_mfma_f32_32x32x16_bf16(kf[s], qf[s], sc, 0, 0, 0);
            float mx = -INFINITY;
#pragma unroll
            for (int r = 0; r < 16; ++r) mx = fmaxf(mx, sc[r]);
            { float mh; const float ml = swap_lo(mx, mh); mx = fmaxf(ml, mh); }
            const float mnew = fmaxf(mrun, mx);
            if (__any(mnew > mrun)) { const float al = __builtin_amdgcn_exp2f(mrun - mnew); lrun *= al;
#pragma unroll
                for (int r = 0; r < 16; ++r) { o0[r] *= al; o1[r] *= al; } }
            mrun = mnew;
            float ps = 0.f;
#pragma unroll
            for (int r = 0; r < 16; ++r) { sc[r] = __builtin_amdgcn_exp2f(sc[r] - mnew); ps += sc[r]; }
            lrun += ps;
            u32x4 p0w, p1w;
            p0w.x = cvtpk(sc[0], sc[1]); p0w.y = cvtpk(sc[2], sc[3]); p0w.z = cvtpk(sc[4], sc[5]); p0w.w = cvtpk(sc[6], sc[7]);
            p1w.x = cvtpk(sc[8], sc[9]); p1w.y = cvtpk(sc[10], sc[11]); p1w.z = cvtpk(sc[12], sc[13]); p1w.w = cvtpk(sc[14], sc[15]);
            const bf16x8 pa0 = __builtin_bit_cast(bf16x8, p0w), pa1 = __builtin_bit_cast(bf16x8, p1w);
#pragma unroll
            for (int s2 = 0; s2 < 2; ++s2)
#pragma unroll
                for (int dt = 0; dt < 2; ++dt) {
                    const int r0 = 16 * s2 + 4 * hh + trq;
                    const LAS unsigned char* a0 = Vl + r0 * 128 + ((64 * dt + trcol2) ^ trsw);
                    const LAS unsigned char* a1 = Vl + (r0 + 8) * 128 + ((64 * dt + trcol2) ^ trsw);
                    const s16x4 lo = __builtin_bit_cast(s16x4, __builtin_amdgcn_ds_read_tr16_b64_v4i16((LAS s16x4*)a0));
                    const s16x4 hi = __builtin_bit_cast(s16x4, __builtin_amdgcn_ds_read_tr16_b64_v4i16((LAS s16x4*)a1));
                    const bf16x8 vf = (bf16x8){lo[0], lo[1], lo[2], lo[3], hi[0], hi[1], hi[2], hi[3]};
                    if (dt == 0) o0 = __builtin_amdgcn_mfma_f32_32x32x16_bf16(vf, s2 ? pa1 : pa0, o0, 0, 0, 0);
                    else         o1 = __builtin_amdgcn_mfma_f32_32x32x16_bf16(vf, s2 ? pa1 : pa0, o1, 0, 0, 0);
                }
        }
        { float lh; const float ll = swap_lo(lrun, lh); lrun = ll + lh; }
        const float inv = 1.0f / lrun;
        bf16_t* op = F.ATT + (size_t)tq * AW + h * 64 + 4 * hh;
#pragma unroll
        for (int g4 = 0; g4 < 4; ++g4) {
            u32x2 w0; w0.x = cvtpk(o0[4 * g4] * inv, o0[4 * g4 + 1] * inv); w0.y = cvtpk(o0[4 * g4 + 2] * inv, o0[4 * g4 + 3] * inv);
            u32x2 w1; w1.x = cvtpk(o1[4 * g4] * inv, o1[4 * g4 + 1] * inv); w1.y = cvtpk(o1[4 * g4 + 2] * inv, o1[4 * g4 + 3] * inv);
            *(u32x2*)(op + 8 * g4) = w0; *(u32x2*)(op + 32 + 8 * g4) = w1;
        }
    }
}

__device__ __forceinline__ void lru_pass_b(Frame& F) {
    const int lane = F.lane, c31 = lane & 31, hh = lane >> 5, n = F.wave;
    LAS float* XCw = (LAS float*)(F.lds + F.wave * 8704);
    LAS float* Y = (LAS float*)(F.lds + 8 * 8704);
    constexpr int YP = 516;
    LruWave W; lru_wave_init(F, n, W);
    for (int chunk = F.vcu; chunk < 256; chunk += F.G) {
        float hc = 0.f;
        { const int ch = 64 * n + 32 * hh + c31, s = chunk >> 3;
          for (int j = 0; j < s; ++j) { const f32x2_t ab = *(const f32x2_t*)(F.SUP + ((size_t)j * LW + ch) * 2); hc = ab.x * hc + ab.y; }
          for (int j = 8 * s; j < chunk; ++j) { const f32x2_t ab = *(const f32x2_t*)(F.AGG + ((size_t)j * LW + ch) * 2); hc = ab.x * hc + ab.y; } }
        float hcar[2]; hcar[0] = swap_lo(hc, hcar[1]);
#pragma unroll 1
        for (int tt = 0; tt < 2; ++tt) {
            const int tb = chunk * 64 + tt * 32;
            bf16x8 af[4];
            lru_tile_prep(F, n, tb, XCw, af);
#pragma unroll
            for (int ct = 0; ct < 2; ++ct) {
                float a[16], bx[16];
                lru_tile_ct(F, W, ct, XCw, af, a, bx);
                float cg[4]; float cc = hcar[ct];
#pragma unroll
                for (int g = 0; g < 4; ++g) {
                    float Ag = 1.f, Bg = 0.f;
#pragma unroll
                    for (int k = 0; k < 4; ++k) { Bg = a[4 * g + k] * Bg + bx[4 * g + k]; Ag *= a[4 * g + k]; }
                    float A1, B1; const float A0 = swap_lo(Ag, A1), B0 = swap_lo(Bg, B1);
                    const float c0 = cc; cc = A0 * cc + B0; const float c1 = cc; cc = A1 * cc + B1;
                    cg[g] = hh ? c1 : c0;
                }
                hcar[ct] = cc;
#pragma unroll
                for (int g = 0; g < 4; ++g) { float hv = cg[g];
#pragma unroll
                    for (int k = 0; k < 4; ++k) { hv = a[4 * g + k] * hv + bx[4 * g + k]; Y[crow(4 * g + k, hh) * YP + 64 * n + 32 * ct + c31] = hv; } }
            }
            __syncthreads();
#pragma unroll
            for (int i = 0; i < 4; ++i) { const int tl = 4 * F.wave + i, t = tb + tl;
                const f32x4 h0 = *(const LAS f32x4*)(Y + tl * YP + 8 * lane), h1 = *(const LAS f32x4*)(Y + tl * YP + 8 * lane + 4);
                const u32x4 gg = *(const u32x4*)(F.Z + (size_t)t * ZP + ZG + 8 * lane);
                float y[8]; y[0] = bflo(gg.x) * h0.x; y[1] = bfhi(gg.x) * h0.y; y[2] = bflo(gg.y) * h0.z; y[3] = bfhi(gg.y) * h0.w;
                y[4] = bflo(gg.z) * h1.x; y[5] = bfhi(gg.z) * h1.y; y[6] = bflo(gg.w) * h1.z; y[7] = bfhi(gg.w) * h1.w;
                float ss = 0.f;
#pragma unroll
                for (int j = 0; j < 8; ++j) ss += y[j] * y[j];
                const float rstd = 1.0f / sqrtf(wave_sum(ss) * (1.f / LW) + EPS);
                const f32x4 g0 = *(const f32x4*)(F.gl + 8 * lane), g1v = *(const f32x4*)(F.gl + 8 * lane + 4);
                u32x4 o; o.x = cvtpk(y[0] * rstd * g0.x, y[1] * rstd * g0.y); o.y = cvtpk(y[2] * rstd * g0.z, y[3] * rstd * g0.w);
                o.z = cvtpk(y[4] * rstd * g1v.x, y[5] * rstd * g1v.y); o.w = cvtpk(y[6] * rstd * g1v.z, y[7] * rstd * g1v.w);
                *(u32x4*)(F.MIX + (size_t)t * D + AW + 8 * lane) = o; }
            __syncthreads();
        }
#pragma unroll 2
        for (int i = 0; i < 8; ++i) { const int t = chunk * 64 + 8 * F.wave + i;
            const u32x4 av = *(const u32x4*)(F.ATT + (size_t)t * AW + 8 * lane);
            float y[8]; y[0] = bflo(av.x); y[1] = bfhi(av.x); y[2] = bflo(av.y); y[3] = bfhi(av.y); y[4] = bflo(av.z); y[5] = bfhi(av.z); y[6] = bflo(av.w); y[7] = bfhi(av.w);
            float ss = 0.f;
#pragma unroll
            for (int j = 0; j < 8; ++j) ss += y[j] * y[j];
            const float rstd = 1.0f / sqrtf(wave_sum(ss) * (1.f / AW) + EPS);
            const f32x4 g0 = *(const f32x4*)(F.ga + 8 * lane), g1v = *(const f32x4*)(F.ga + 8 * lane + 4);
            u32x4 o; o.x = cvtpk(y[0] * rstd * g0.x, y[1] * rstd * g0.y); o.y = cvtpk(y[2] * rstd * g0.z, y[3] * rstd * g0.w);
            o.z = cvtpk(y[4] * rstd * g1v.x, y[5] * rstd * g1v.y); o.w = cvtpk(y[6] * rstd * g1v.z, y[7] * rstd * g1v.w);
            *(u32x4*)(F.MIX + (size_t)t * D + 8 * lane) = o; }
    }
}

__device__ __forceinline__ void norm_rows_bf16(Frame& F, const float* src, const float* g, bf16_t* dst) {
    const int gw = F.vcu * 8 + F.wave, NGW = F.G * 8;
    for (int m = gw; m < M; m += NGW) rms_row_to_bf16(src + (size_t)m * D, g, dst + (size_t)m * D, F.lane);
}
__device__ __forceinline__ void norm_rows_f32_inplace(Frame& F, float* buf, const float* g) {
    const int gw = F.vcu * 8 + F.wave, NGW = F.G * 8;
    for (int m = gw; m < M; m += NGW) {
        f32x4* xr = (f32x4*)(buf + (size_t)m * D) + F.lane; const f32x4* gr = (const f32x4*)g + F.lane;
        f32x4 v[4]; float s = 0.f;
#pragma unroll
        for (int j = 0; j < 4; ++j) { v[j] = xr[64 * j]; s += (v[j].x * v[j].x + v[j].y * v[j].y) + (v[j].z * v[j].z + v[j].w * v[j].w); }
        const float rstd = 1.0f / sqrtf(wave_sum(s) * (1.f / D) + EPS);
#pragma unroll
        for (int j = 0; j < 4; ++j) xr[64 * j] = v[j] * rstd * gr[64 * j];
    }
}

constexpr int N_PHASES = 9;
struct Args { const float* in[17]; float* out; unsigned char* ws; int ph_lo, ph_hi; float invf[8]; };
__global__ void __launch_bounds__(512, 2) fwd_kernel(Args args) {
    __shared__ __attribute__((aligned(1024))) unsigned char lds_raw[LDS_BYTES];
    Frame F;
    F.lds = (LAS unsigned char*)lds_raw;
    volatile LAS unsigned* MISC = (volatile LAS unsigned*)(F.lds + MISC_OFF);
    F.tid = threadIdx.x; F.lane = F.tid & 63; F.wave = __builtin_amdgcn_readfirstlane(F.tid >> 6);
    F.G = gridDim.x; { const int bx = blockIdx.x; F.vcu = (F.G % 8 == 0) ? (bx % 8) * (F.G / 8) + bx / 8 : bx; }
    unsigned char* ws = args.ws;
    F.x = args.in[0]; F.g1 = args.in[1]; F.w_in = args.in[2]; F.conv_w = args.in[3]; F.conv_b = args.in[4]; F.w_r = args.in[5]; F.b_r = args.in[6]; F.w_i = args.in[7]; F.b_i = args.in[8];
    F.lam = args.in[9]; F.ga = args.in[10]; F.gl = args.in[11]; F.w_out = args.in[12]; F.g2 = args.in[13]; F.w_up = args.in[14]; F.w_dn = args.in[15]; F.gf = args.in[16];
    F.out = args.out;
    F.Win_t = (bf16_t*)(ws + WS_WIN); F.Wout_t = (bf16_t*)(ws + WS_WOUT); F.Wup_t = (bf16_t*)(ws + WS_WUP); F.Wdn_t = (bf16_t*)(ws + WS_WDN);
    F.WtR = (bf16_t*)(ws + WS_WG); F.WtI = F.WtR + 32768;
    F.XN = (bf16_t*)(ws + WS_XN); F.Z = (bf16_t*)(ws + WS_Z); F.ATT = (bf16_t*)(ws + WS_ATT); F.MIX = (bf16_t*)(ws + WS_MIX); F.H = (bf16_t*)(ws + WS_H);
    F.rope = (float*)(ws + WS_ROPE); F.AGG = (float*)(ws + WS_AGG); F.SUP = (float*)(ws + WS_SUP);
#pragma unroll
    for (int i = 0; i < 8; ++i) F.invf[i] = args.invf[i];
    if (F.tid < 64) MISC[F.tid] = 0u;
    __syncthreads();
    const int lo = args.ph_lo, hi = args.ph_hi;
    XcdBarrier bar; bar.bar = (unsigned*)(ws + WS_CTL) + CW_BAR; bar.x = 0; bar.st = nullptr;
    if (hi - lo > 1) bar = xcd_barrier_post((unsigned*)(ws + WS_CTL) + CW_BAR, MISC);
#ifndef PH_MASK
#define PH_MASK 0x1ff
#endif
#define IN(k) (((PH_MASK >> (k)) & 1) && lo <= (k) && (k) < hi)
#define SEAM(k) do { if (IN(k) && IN((k) + 1)) xcd_barrier(bar); } while (0)

    if (IN(0)) { p0_prologue(F); } SEAM(0);
    if (IN(1)) { pg8::Gemm g{F.XN, F.Win_t, M, NZ, D}; pg8::StaticOrder S; S.init(M, NZ, F.G, (int)blockIdx.x);
        EpiZ E{F.Z, F.rope}; pg8::gemm_phase<EpiZ, pg8::StaticOrder, true, true>(F.lds, g, S, E); } SEAM(1);
    if (IN(2)) { lru_pass_a(F); attn_phase(F); } SEAM(2);
    if (IN(3)) { lru_pass_b(F); } SEAM(3);
    if (IN(4)) { pg8::Gemm g{F.MIX, F.Wout_t, M, D, D}; pg8::StaticOrder S; S.init(M, D, F.G, (int)blockIdx.x);
        EpiRes E{F.x, F.out}; pg8::gemm_phase<EpiRes, pg8::StaticOrder, true, true>(F.lds, g, S, E); } SEAM(4);
    if (IN(5)) { norm_rows_bf16(F, F.out, F.g2, F.XN); } SEAM(5);
    if (IN(6)) { pg8::Gemm g{F.XN, F.Wup_t, M, FF, D}; pg8::StaticOrder S; S.init(M, FF, F.G, (int)blockIdx.x);
        EpiRelu2 E{F.H}; pg8::gemm_phase<EpiRelu2, pg8::StaticOrder, true, true>(F.lds, g, S, E); } SEAM(6);
    if (IN(7)) { pg8::Gemm g{F.H, F.Wdn_t, M, D, FF}; pg8::StaticOrder S; S.init(M, D, F.G, (int)blockIdx.x);
        EpiRes E{F.out, F.out}; pg8::gemm_phase<EpiRes, pg8::StaticOrder, true, true>(F.lds, g, S, E); } SEAM(7);
    if (IN(8)) { norm_rows_f32_inplace(F, F.out, F.gf); }
#undef IN
#undef SEAM
}

#ifdef PROBE_CUT
__global__ void dump_kernel(float* out, const unsigned char* ws) {
    const bf16_t* Z = (const bf16_t*)(ws + WS_Z); const bf16_t* ATT = (const bf16_t*)(ws + WS_ATT); const bf16_t* MIX = (const bf16_t*)(ws + WS_MIX);
    const bf16_t* XN = (const bf16_t*)(ws + WS_XN); const bf16_t* H = (const bf16_t*)(ws + WS_H); const float* AGG = (const float*)(ws + WS_AGG); const float* SUP = (const float*)(ws + WS_SUP);
    for (size_t i = (size_t)blockIdx.x * blockDim.x + threadIdx.x; i < (size_t)M * D; i += (size_t)gridDim.x * blockDim.x) {
        const int t = (int)(i >> 10), c = (int)(i & 1023); float v = 0.f;
        if (PROBE_CUT == 0) v = bf2f(XN[i]);
        if (PROBE_CUT == 1) v = bf2f(Z[(size_t)t * ZP + c]) + bf2f(Z[(size_t)t * ZP + c + 1024]) + (c < 512 ? bf2f(Z[(size_t)t * ZP + c + 2048]) : 0.f);
        if (PROBE_CUT == 2) v = bf2f(ATT[(size_t)t * AW + (c & 511)]) + (c < 512 ? AGG[(size_t)(t & 255) * 1024 + c + ((t >> 8) & 1) * 512] : SUP[(size_t)(t & 31) * 1024 + (c & 511) + ((t >> 8) & 1) * 512]);
        if (PROBE_CUT == 3) v = bf2f(MIX[i]);
        if (PROBE_CUT == 5) v = bf2f(XN[i]);
        if (PROBE_CUT == 6) v = bf2f(H[(size_t)t * FF + c]) + bf2f(H[(size_t)t * FF + c + 1024]) + bf2f(H[(size_t)t * FF + c + 2048]) + bf2f(H[(size_t)t * FF + c + 3072]);
        if (PROBE_CUT != 4 && PROBE_CUT != 7) out[i] = v;
    }
}
#endif
extern "C" void kernel_launch(void* const* d_in, const int* in_sizes, int n_in, void* d_out, int out_size, void* d_ws, size_t ws_size, hipStream_t stream) {
    static int grid = 0;
    if (grid == 0) {
        if (n_in != 17 || in_sizes[0] != M * D || out_size != M * D || ws_size < WS_END) { fprintf(stderr, "kernel_launch: unexpected shapes (n_in %d, in0 %d, out %d, ws %zu)\n", n_in, n_in > 0 ? in_sizes[0] : -1, out_size, ws_size); grid = -1; return; }
        int dev = 0, cus = 0, per_cu = 0;
        if (hipGetDevice(&dev) != hipSuccess || hipDeviceGetAttribute(&cus, hipDeviceAttributeMultiprocessorCount, dev) != hipSuccess) { grid = -1; return; }
        if (hipOccupancyMaxActiveBlocksPerMultiprocessor(&per_cu, (const void*)fwd_kernel, 512, 0) != hipSuccess || per_cu < 1) { fprintf(stderr, "kernel_launch: occupancy query says %d blocks per CU\n", per_cu); per_cu = 1; }
        (void)hipGetLastError();
        grid = cus;
    }
    if (grid < 0) return;
    if (hipMemsetAsync((char*)d_ws + WS_CTL, 0, CTL_ZERO_BYTES, stream) != hipSuccess) return;
    Args a{};
    for (int i = 0; i < 17; ++i) a.in[i] = (const float*)d_in[i];
    a.out = (float*)d_out; a.ws = (unsigned char*)d_ws;
    for (int i = 0; i < 8; ++i) a.invf[i] = (float)pow(500000.0, -(double)i / 8.0);
#if MK_N_LAUNCHES == 1
    a.ph_lo = 0; a.ph_hi = N_PHASES;
    hipLaunchKernelGGL(fwd_kernel, dim3(grid), dim3(512), 0, stream, a);
#else
#ifdef PROBE_CUT
    for (int p = 0; p <= PROBE_CUT; ++p) { a.ph_lo = p; a.ph_hi = p + 1; hipLaunchKernelGGL(fwd_kernel, dim3(grid), dim3(512), 0, stream, a); }
    hipLaunchKernelGGL(dump_kernel, dim3(2048), dim3(256), 0, stream, (float*)d_out, (const unsigned char*)d_ws);
#else
    for (int p = 0; p < N_PHASES; ++p) { a.ph_lo = p; a.ph_hi = p + 1; hipLaunchKernelGGL(fwd_kernel, dim3(grid), dim3(512), 0, stream, a); }
#endif
#endif
}
```
